# Optimizing an MI355X kernel written in HIP

```python
import math
import jax, jax.numpy as jnp
from jax import lax
import numpy as np

D_MODEL = 2048
BATCH = 4
SEQ = 2048
DEPTH = 4
DEC_BATCH = 32
DEC_SEQ = 1
PAST_LEN = 16384
PAGE_SIZE = 128

N_A_LAYERS = DEPTH // 2
N_B_LAYERS = DEPTH - N_A_LAYERS
D_POOL = D_MODEL
POOL_WINDOWS = (2, 4, 8, 16)
N_POOL_GROUPS = len(POOL_WINDOWS)
POOL_GROUP = D_POOL // N_POOL_GROUPS
POOL_STATE = max(POOL_WINDOWS) - 1
HEAD_DIM = 64
N_HEADS = D_MODEL // HEAD_DIM
N_KV_HEADS = N_HEADS // 8
GROUP = N_HEADS // N_KV_HEADS
D_ATTN = N_HEADS * HEAD_DIM
KV_DIM = N_KV_HEADS * HEAD_DIM
WINDOW = 128
ROT_DIM = HEAD_DIM // 4
ROPE_THETA = 500000.0
ALPHA = (2 * DEPTH) ** 0.25
BETA = (8 * DEPTH) ** -0.25
LN_EPS = 1e-5
NEG = -1e30

kernel_name = "yoco_pool_swa_sink_decoder_step"


def layer_norm(x, g, b):
    xf = x.astype(jnp.float32)
    mu = jnp.mean(xf, axis=-1, keepdims=True)
    var = jnp.mean(jnp.square(xf - mu), axis=-1, keepdims=True)
    return ((xf - mu) * lax.rsqrt(var + LN_EPS) * g.astype(jnp.float32) + b.astype(jnp.float32)).astype(x.dtype)


def rope_partial(x, pos):
    half = ROT_DIM // 2
    inv_freq = ROPE_THETA ** (-jnp.arange(0, ROT_DIM, 2, dtype=jnp.float32) / ROT_DIM)
    ang = pos.astype(jnp.float32)[:, None] * inv_freq[None, :]
    cos = jnp.cos(ang)[:, None, :]
    sin = jnp.sin(ang)[:, None, :]
    xf = x.astype(jnp.float32)
    x1, x2, rest = xf[..., :half], xf[..., half:ROT_DIM], xf[..., ROT_DIM:]
    out = jnp.concatenate([x1 * cos - x2 * sin, x2 * cos + x1 * sin, rest], axis=-1)
    return out.astype(x.dtype)


def multiscale_pool(u, prefix, pos):
    T = u.shape[1]
    P = POOL_STATE
    ext = jnp.concatenate([prefix.astype(u.dtype), u], axis=1)
    extf = ext.astype(jnp.float32)
    c = jnp.cumsum(extf, axis=1)
    c = jnp.concatenate([jnp.zeros_like(c[:, :1]), c], axis=1)
    hi = c[:, P + 1:P + 1 + T]
    outs = []
    for g, w in enumerate(POOL_WINDOWS):
        sl = slice(g * POOL_GROUP, (g + 1) * POOL_GROUP)
        lo = c[:, P + 1 - w:P + 1 - w + T, sl]
        cnt = jnp.minimum(w, pos + 1).astype(jnp.float32)[None, :, None]
        outs.append((hi[..., sl] - lo) / cnt)
    pooled = jnp.concatenate(outs, axis=-1) - extf[:, P:]
    return pooled.astype(u.dtype), ext[:, -P:]


def pool_layer(x, prefix, pos, w_in, w_grp, scale, w_out, g_ln, b_ln):
    B, T, _ = x.shape
    z = x @ w_in
    u, gate = z[..., :D_POOL], z[..., D_POOL:]
    d, new_state = multiscale_pool(u, prefix, pos)
    d = jnp.einsum('btgc,gce->btge', d.reshape(B, T, N_POOL_GROUPS, POOL_GROUP), w_grp)
    d = d.reshape(B, T, D_POOL) * scale
    y = (d * jax.nn.silu(gate)) @ w_out
    return layer_norm(ALPHA * x + y, g_ln, b_ln), new_state


def shared_kv(h, pos, w_kv):
    B, T, _ = h.shape
    kv = h @ w_kv
    k = kv[..., :KV_DIM].reshape(B, T, N_KV_HEADS, HEAD_DIM)
    v = kv[..., KV_DIM:].reshape(B, T, N_KV_HEADS, HEAD_DIM)
    return rope_partial(k, pos), v


def attn_core(q, k, v, q_pos, k_pos, sinks):
    s = jnp.einsum('...qkgd,...skd->...kgqs', q, k).astype(jnp.float32) * (HEAD_DIM ** -0.5)
    qp = q_pos[..., :, None]
    kp = k_pos[..., None, :]
    mask = (kp <= qp) & (qp - kp < WINDOW) & (kp >= 0)
    s = jnp.where(mask[..., None, None, :, :], s, NEG)
    sink = sinks.astype(jnp.float32).reshape(N_KV_HEADS, GROUP)[:, :, None, None]
    m = jnp.maximum(jnp.max(s, axis=-1, keepdims=True), sink)
    p = jnp.exp(s - m)
    p = p / (jnp.sum(p, axis=-1, keepdims=True) + jnp.exp(sink - m))
    return jnp.einsum('...kgqs,...skd->...qkgd', p.astype(v.dtype), v)


def attn_layer(x, pos, kb, vb, k_pos, q_pos, blocked, w_in, sinks, w_out, g_ln, b_ln):
    B, T, _ = x.shape
    z = x @ w_in
    q = rope_partial(z[..., :D_ATTN].reshape(B, T, N_HEADS, HEAD_DIM), pos)
    gate = z[..., D_ATTN:]
    if blocked:
        nb = T // WINDOW
        q = q.reshape(B, nb, WINDOW, N_KV_HEADS, GROUP, HEAD_DIM)
    else:
        q = q.reshape(B, T, N_KV_HEADS, GROUP, HEAD_DIM)
    o = attn_core(q, kb, vb, q_pos, k_pos, sinks).reshape(B, T, D_ATTN)
    y = (o * jax.nn.silu(gate)) @ w_out
    return layer_norm(ALPHA * x + y, g_ln, b_ln)


def banded_blocks(a):
    B, S = a.shape[:2]
    nb = S // WINDOW
    ax = jnp.concatenate([jnp.zeros_like(a[:, :WINDOW]), a], axis=1)
    ax = ax.reshape(B, nb + 1, WINDOW, *a.shape[2:])
    return jnp.concatenate([ax[:, :-1], ax[:, 1:]], axis=2)


def setup_inputs(seed: int = 0) -> dict:
    key = jax.random.key(seed)
    ks = jax.random.split(key, 20)
    f32 = jnp.float32
    nrm = lambda k, shape, s: jax.random.normal(k, shape, f32) * s
    w_kv = jnp.concatenate([nrm(ks[9], (D_MODEL, KV_DIM), D_MODEL ** -0.5),
                            nrm(ks[10], (D_MODEL, KV_DIM), BETA * D_MODEL ** -0.5)], axis=1)
    return {
        "x_prompt": nrm(ks[0], (BATCH, SEQ, D_MODEL), 1.0),
        "x_sample": nrm(ks[1], (DEC_BATCH, DEC_SEQ, D_MODEL), 1.0),
        "state_pool": nrm(ks[2], (N_A_LAYERS, DEC_BATCH, POOL_STATE, D_POOL), 1.0),
        "cache_k": nrm(ks[3], (DEC_BATCH, WINDOW, N_KV_HEADS, HEAD_DIM), 1.0),
        "cache_v": nrm(ks[4], (DEC_BATCH, WINDOW, N_KV_HEADS, HEAD_DIM), BETA),
        "w_in_a": nrm(ks[5], (N_A_LAYERS, D_MODEL, 2 * D_POOL), D_MODEL ** -0.5),
        "w_grp_a": nrm(ks[6], (N_A_LAYERS, N_POOL_GROUPS, POOL_GROUP, POOL_GROUP), POOL_GROUP ** -0.5),
        "scale_a": 1.0 + nrm(ks[7], (N_A_LAYERS, D_POOL), 0.1),
        "w_out_a": nrm(ks[8], (N_A_LAYERS, D_POOL, D_MODEL), BETA * D_POOL ** -0.5),
        "w_kv": w_kv,
        "w_in_b": nrm(ks[11], (N_B_LAYERS, D_MODEL, 2 * D_ATTN), D_MODEL ** -0.5),
        "sinks_b": nrm(ks[12], (N_B_LAYERS, N_HEADS), 1.0),
        "w_out_b": nrm(ks[13], (N_B_LAYERS, D_ATTN, D_MODEL), BETA * D_ATTN ** -0.5),
        "ln_g": 1.0 + nrm(ks[14], (DEPTH, D_MODEL), 0.1),
        "ln_b": nrm(ks[15], (DEPTH, D_MODEL), 0.1),
    }


def reference(x_prompt, x_sample, state_pool, cache_k, cache_v, w_in_a, w_grp_a, scale_a, w_out_a,
              w_kv, w_in_b, sinks_b, w_out_b, ln_g, ln_b):
    S = x_prompt.shape[1]
    T = x_sample.shape[1]
    pos_p = jnp.arange(S, dtype=jnp.int32)
    pos_s = PAST_LEN + jnp.arange(T, dtype=jnp.int32)
    xp, xs = x_prompt, x_sample
    prefix_p = jnp.zeros((xp.shape[0], POOL_STATE, D_POOL), xp.dtype)
    pool_p, pool_s = [], []
    for i in range(DEPTH):
        if i < N_A_LAYERS:
            xp, sp = pool_layer(xp, prefix_p, pos_p, w_in_a[i], w_grp_a[i], scale_a[i], w_out_a[i], ln_g[i], ln_b[i])
            xs, ss = pool_layer(xs, state_pool[i], pos_s, w_in_a[i], w_grp_a[i], scale_a[i], w_out_a[i], ln_g[i], ln_b[i])
            pool_p.append(sp)
            pool_s.append(ss)
            if i == N_A_LAYERS - 1:
                k_p, v_p = shared_kv(xp, pos_p, w_kv)
                k_s, v_s = shared_kv(xs, pos_s, w_kv)
                kb_p, vb_p = banded_blocks(k_p), banded_blocks(v_p)
                kpos_x = jnp.arange(-WINDOW, S, dtype=jnp.int32).reshape(S // WINDOW + 1, WINDOW)
                kpos_p = jnp.concatenate([kpos_x[:-1], kpos_x[1:]], axis=1)
                qpos_p = pos_p.reshape(S // WINDOW, WINDOW)
                kx_s = jnp.concatenate([cache_k.astype(k_s.dtype), k_s], axis=1)
                vx_s = jnp.concatenate([cache_v.astype(v_s.dtype), v_s], axis=1)
                kpos_s = PAST_LEN - WINDOW + jnp.arange(WINDOW + T, dtype=jnp.int32)
        else:
            j = i - N_A_LAYERS
            xp = attn_layer(xp, pos_p, kb_p, vb_p, kpos_p, qpos_p, True,
                            w_in_b[j], sinks_b[j], w_out_b[j], ln_g[i], ln_b[i])
            xs = attn_layer(xs, pos_s, kx_s, vx_s, kpos_s, pos_s, False,
                            w_in_b[j], sinks_b[j], w_out_b[j], ln_g[i], ln_b[i])
    new_pool_prompt = jnp.stack(pool_p, axis=0)
    new_pool_sample = jnp.stack(pool_s, axis=0)
    new_k_prompt = k_p[:, -WINDOW:]
    new_v_prompt = v_p[:, -WINDOW:]
    new_k_sample = kx_s[:, -WINDOW:]
    new_v_sample = vx_s[:, -WINDOW:]
    return (xp, xs, new_pool_prompt, new_pool_sample, new_k_prompt, new_v_prompt, new_k_sample, new_v_sample)
```

```cpp
#include <hip/hip_runtime.h>
#include <cstdio>
#include <cstdint>

#define LAS __attribute__((address_space(3)))
typedef unsigned short bf16;
typedef short bf16x8 __attribute__((ext_vector_type(8)));
typedef short s16x4 __attribute__((ext_vector_type(4)));
typedef float f32x4 __attribute__((ext_vector_type(4)));
typedef float f32x16 __attribute__((ext_vector_type(16)));
typedef unsigned u32x4 __attribute__((ext_vector_type(4)));
typedef unsigned u32x2 __attribute__((ext_vector_type(2)));

constexpr int SEQ = 2048, NBATCH = 4, M = NBATCH * SEQ, DM = 2048, NSMP = 32, PAST = 16384;
constexpr int PST = 15, WIN = 128, NH = 32, NKV = 4, HD = 64, KVD = 256;
constexpr float ALPHA = 1.6817928305074290f;
constexpr float LN_EPS = 1e-5f;
constexpr float LOG2E = 1.4426950408889634f;
constexpr float QSCALE = 0.125f * LOG2E;
constexpr int NWAVES = 8;

constexpr size_t O_YP = 0, O_YS = O_YP + (size_t)M * DM, O_PP = O_YS + (size_t)NSMP * DM, O_PS = O_PP + (size_t)2 * NBATCH * PST * DM,
                 O_KP = O_PS + (size_t)2 * NSMP * PST * DM, O_VP = O_KP + (size_t)NBATCH * WIN * KVD, O_KS = O_VP + (size_t)NBATCH * WIN * KVD,
                 O_VS = O_KS + (size_t)NSMP * WIN * KVD, O_END = O_VS + (size_t)NSMP * WIN * KVD;

constexpr size_t MiB = 1u << 20;
constexpr size_t WS_CTL = 0, CTL_ZERO_BYTES = 64 * 1024;
constexpr size_t WS_WINA = 2 * MiB, WS_WGRP = 34 * MiB, WS_WOUTA = 38 * MiB, WS_WKV = 54 * MiB, WS_WINB = 56 * MiB, WS_WOUTB = 88 * MiB;
constexpr size_t WS_XB = 104 * MiB, WS_U = 136 * MiB, WS_G = 168 * MiB, WS_D = 200 * MiB, WS_KB = 232 * MiB, WS_VB = 236 * MiB;
constexpr size_t WS_SMP = 240 * MiB;
constexpr size_t SM_XSB = WS_SMP, SM_US = SM_XSB + 128 * 1024, SM_GS = SM_US + 256 * 1024, SM_DSB = SM_GS + 256 * 1024, SM_ESB = SM_DSB + 128 * 1024,
                 SM_QS = SM_ESB + 128 * 1024, SM_END = SM_QS + 256 * 1024;
constexpr size_t WS_ROPE = 242 * MiB;
constexpr size_t WS_END = 243 * MiB;
static_assert(SM_END <= WS_ROPE, "ws map");
constexpr int CW_BAR = 1024;

constexpr int RING_BYTES = 131072, MISC_OFF = RING_BYTES + 320, LDS_BYTES = 147456;

__device__ __forceinline__ int fresh_tid() { int t = threadIdx.x; asm volatile("" : "+v"(t)); return t; }
__device__ __forceinline__ unsigned f2bf(float f) { unsigned u = __builtin_bit_cast(unsigned, f); return (u + 0x7fffu + ((u >> 16) & 1u)) >> 16; }
__device__ __forceinline__ unsigned pk2(float lo, float hi) { return f2bf(lo) | (f2bf(hi) << 16); }
__device__ __forceinline__ float bf2f(unsigned short b) { return __builtin_bit_cast(float, (unsigned)b << 16); }
__device__ __forceinline__ unsigned cvt_pk_bf16(float lo, float hi) { unsigned r; asm volatile("v_cvt_pk_bf16_f32 %0, %1, %2" : "=v"(r) : "v"(lo), "v"(hi)); return r; }
__device__ __forceinline__ float silu_f(float v) { return v / (1.0f + __expf(-v)); }
__device__ __forceinline__ f32x4 silu4(f32x4 v) { return (f32x4){silu_f(v[0]), silu_f(v[1]), silu_f(v[2]), silu_f(v[3])}; }

namespace pg8 {
constexpr int BM = 256, BK = 64, HALF = 128, HTB = HALF * BK * 2, STAGE_BYTES = 8 * HTB, NXCD = 8, WGM = 8;
__host__ __device__ __forceinline__ int lds_byte(int r, int c) { const int st = (r >> 4) * 2 + (c >> 5), rr = r & 15, cc = c & 31, ob = rr * 64 + cc * 2; return st * 1024 + (ob ^ (((ob >> 9) & 1) << 5)); }
__host__ __device__ __forceinline__ void stage_rc(int b, int& R, int& C) { const int st = b / 1024, sb = b % 1024, swz = sb ^ (((sb >> 9) & 1) << 5); R = (st >> 1) * 16 + swz / 64; C = (st & 1) * 32 + (swz % 64) / 2; }
__host__ __device__ __forceinline__ int perm32(int rho) { const int n = rho >> 4, i = rho & 15; return 8 * (i >> 2) + 4 * n + (i & 3); }

struct Unit { int pm, pn; };
struct Gemm { const bf16* A; const bf16* Bt; int lda, ldb, K, grp; };

struct StaticOrder {
    int nM, nN, nwg, G, c;
    __device__ void init(int M_, int N_, int G_, int c_) { nM = M_ / BM; nN = N_ / BM; nwg = nM * nN; G = G_; c = c_; }
    __device__ bool next(int i, Unit& u) const {
        const long L = (long)i * G + c; if (L >= nwg) return false;
        int wgid = (int)L; { const int q = nwg / NXCD, r = nwg % NXCD, xcd = wgid % NXCD, off = wgid / NXCD; wgid = (xcd < r ? xcd * (q + 1) : r * (q + 1) + (xcd - r) * q) + off; }
        const int nig = WGM * nN, gid = wgid / nig, fm = gid * WGM, gsz = (nM - fm) < WGM ? (nM - fm) : WGM;
        u.pm = fm + ((wgid % nig) % gsz); u.pn = (wgid % nig) / gsz; return true;
    }
};

template <class Epi, class Sched, bool ALIGN_EPI>
__device__ __forceinline__ void gemm_phase(LAS unsigned char* lds, const Gemm g, const Sched& S, const Epi& E) {
    const int tid = fresh_tid(), wid = __builtin_amdgcn_readfirstlane(tid >> 6), lane = tid & 63, wr = wid >> 2, wc = wid & 3, fr = lane & 15, fq = lane >> 4;
    const int K = g.K, nt = K / BK;
    unsigned voffA[2], voffB[2];
#pragma unroll
    for (int i = 0; i < 2; ++i) { int R, C; stage_rc(tid * 16 + i * 8192, R, C); const int Rb = Epi::PERM ? ((R & ~31) + perm32(R & 31)) : R;
        voffA[i] = (unsigned)(R * g.lda + C) * 2u; voffB[i] = (unsigned)(Rb * g.ldb + C) * 2u; }
    const size_t kstep = (size_t)(BK * 2);
    const size_t hstepA = (size_t)HALF * g.lda * 2, hstepB = (size_t)HALF * g.ldb * 2;
    const size_t tstepA = 2 * hstepA, tstepB = 2 * hstepB;
    const unsigned ldsw = (unsigned)wid * 1024u;
    const int aoff = lds_byte(wr * 64 + fr, fq * 8), boff = lds_byte(wc * 32 + fr, fq * 8);
#define PG8_SA(b, h) (((b) * 2 + (h)) * HTB)
#define PG8_SB(b, h) ((4 + (b) * 2 + (h)) * HTB)
#define PG8_STAGE(bufoff, gbase, voff) do { _Pragma("unroll") for (int _i = 0; _i < 2; ++_i) \
        __builtin_amdgcn_global_load_lds((const unsigned*)((const char*)(gbase) + (voff)[_i]), (LAS unsigned*)(lds + (bufoff) + ldsw + _i * 8192), 16, 0, 0); } while (0)
#define PG8_LDA(dst, b, h) do { _Pragma("unroll") for (int m = 0; m < 4; ++m) _Pragma("unroll") for (int k = 0; k < 2; ++k) dst[m][k] = *(const LAS bf16x8*)(lds + PG8_SA(b, h) + aoff + m * 2048 + k * 1024); } while (0)
#define PG8_LDB(dst, b, h) do { _Pragma("unroll") for (int n = 0; n < 2; ++n) _Pragma("unroll") for (int k = 0; k < 2; ++k) dst[n][k] = *(const LAS bf16x8*)(lds + PG8_SB(b, h) + boff + n * 2048 + k * 1024); } while (0)
#define PG8_MMA(ai, bj, At, Bt) do { __builtin_amdgcn_s_setprio(1); _Pragma("unroll") for (int m = 0; m < 4; ++m) _Pragma("unroll") for (int n = 0; n < 2; ++n) _Pragma("unroll") for (int k = 0; k < 2; ++k) \
        acc[ai][bj][m][n] = __builtin_amdgcn_mfma_f32_16x16x32_bf16(Bt[n][k], At[m][k], acc[ai][bj][m][n], 0, 0, 0); __builtin_amdgcn_s_setprio(0); } while (0)
#define PG8_WAIT_V(n) asm volatile("s_waitcnt vmcnt(" #n ")" ::: "memory")
#define PG8_WAIT_L(n) asm volatile("s_waitcnt lgkmcnt(" #n ")" ::: "memory")
#define PG8_BAR __builtin_amdgcn_s_barrier()
#define PG8_SCHED __builtin_amdgcn_sched_barrier(0)
#define PG8_APTR(u) ((const char*)g.A + (size_t)(u).pm * tstepA + (g.grp ? (size_t)((u).pn >> 1) * 1024 : (size_t)0))
#define PG8_BPTR(u) ((const char*)g.Bt + (size_t)(u).pn * tstepB)
    Unit cur, nxt; int ui = 0;
    if (!S.next(0, cur)) return;
    f32x4 acc[2][2][4][2];
#pragma unroll
    for (int a = 0; a < 2; ++a)
#pragma unroll
        for (int b = 0; b < 2; ++b)
#pragma unroll
            for (int m = 0; m < 4; ++m)
#pragma unroll
                for (int n = 0; n < 2; ++n) acc[a][b][m][n] = (f32x4){0.f, 0.f, 0.f, 0.f};
    bf16x8 At[4][2], B0[2][2], B1[2][2];
    const char* cA = PG8_APTR(cur); const char* cB = PG8_BPTR(cur);
    PG8_STAGE(PG8_SB(0, 0), cB, voffB); PG8_STAGE(PG8_SB(0, 1), cB + hstepB, voffB); PG8_STAGE(PG8_SA(0, 0), cA, voffA); PG8_STAGE(PG8_SA(0, 1), cA + hstepA, voffA);
    if (wr == 1) PG8_BAR;
    PG8_WAIT_V(2); PG8_BAR;
    PG8_STAGE(PG8_SB(1, 0), cB + kstep, voffB); PG8_STAGE(PG8_SA(1, 0), cA + kstep, voffA); PG8_STAGE(PG8_SB(1, 1), cB + hstepB + kstep, voffB);
    PG8_WAIT_V(6); PG8_BAR;
    for (;;) {
        const bool has_next = S.next(ui + 1, nxt);
        const char* nA = has_next ? PG8_APTR(nxt) : cA; const char* nB = has_next ? PG8_BPTR(nxt) : cB;
        for (int t = 0; t < nt; t += 2) {
            const bool last = (t == nt - 2);
            const char* a1 = cA + (size_t)(t + 1) * kstep;
            const char* a2 = last ? nA : cA + (size_t)(t + 2) * kstep; const char* b2 = last ? nB : cB + (size_t)(t + 2) * kstep;
            const char* a3 = a2 + kstep; const char* b3 = b2 + kstep;
            PG8_LDB(B0, 0, 0); PG8_LDB(B1, 0, 1); PG8_SCHED; PG8_LDA(At, 0, 0); PG8_STAGE(PG8_SA(1, 1), a1 + hstepA, voffA);
            PG8_WAIT_V(8); PG8_WAIT_L(0); PG8_BAR; PG8_MMA(0, 0, At, B0); PG8_MMA(0, 1, At, B1); PG8_BAR; PG8_SCHED;
            PG8_LDA(At, 0, 1); PG8_STAGE(PG8_SB(0, 0), b2, voffB); PG8_STAGE(PG8_SB(0, 1), b2 + hstepB, voffB); PG8_STAGE(PG8_SA(0, 0), a2, voffA);
            PG8_WAIT_V(8); PG8_WAIT_L(0); PG8_BAR; PG8_MMA(1, 0, At, B0); PG8_MMA(1, 1, At, B1); PG8_BAR; PG8_SCHED;
            PG8_LDB(B0, 1, 0); PG8_LDB(B1, 1, 1); PG8_SCHED; PG8_LDA(At, 1, 0); PG8_STAGE(PG8_SA(0, 1), a2 + hstepA, voffA);
            PG8_WAIT_V(8); PG8_WAIT_L(0); PG8_BAR; PG8_MMA(0, 0, At, B0); PG8_MMA(0, 1, At, B1); PG8_BAR; PG8_SCHED;
            PG8_LDA(At, 1, 1); PG8_STAGE(PG8_SB(1, 0), b3, voffB); PG8_STAGE(PG8_SB(1, 1), b3 + hstepB, voffB); PG8_STAGE(PG8_SA(1, 0), a3, voffA);
            PG8_WAIT_V(8); PG8_WAIT_L(0); PG8_BAR; PG8_MMA(1, 0, At, B0); PG8_MMA(1, 1, At, B1); PG8_BAR; PG8_SCHED;
        }
        if constexpr (ALIGN_EPI) { if (wr == 0) PG8_BAR; }
        E(acc, cur, wr, wc, fr, fq);
        if (!has_next) break;
#pragma unroll
        for (int a = 0; a < 2; ++a)
#pragma unroll
            for (int b = 0; b < 2; ++b)
#pragma unroll
                for (int m = 0; m < 4; ++m)
#pragma unroll
                    for (int n = 0; n < 2; ++n) acc[a][b][m][n] = (f32x4){0.f, 0.f, 0.f, 0.f};
        cur = nxt; cA = nA; cB = nB; ++ui;
        if constexpr (ALIGN_EPI) { if (wr == 1) PG8_BAR; }
    }
    PG8_WAIT_V(0);
    if constexpr (!ALIGN_EPI) { if (wr == 0) PG8_BAR; }
    PG8_BAR;
#undef PG8_SA
#undef PG8_SB
#undef PG8_STAGE
#undef PG8_LDA
#undef PG8_LDB
#undef PG8_MMA
#undef PG8_WAIT_V
#undef PG8_WAIT_L
#undef PG8_BAR
#undef PG8_SCHED
#undef PG8_APTR
#undef PG8_BPTR
}
}

__device__ __forceinline__ void rope_perm(f32x4& v0, f32x4& v1, const float* cosr, const float* sinr, int fq) {
    f32x4 p0, p1;
#pragma unroll
    for (int j = 0; j < 4; ++j) { p0[j] = __shfl_xor(v0[j], 16); p1[j] = __shfl_xor(v1[j], 16); }
    if (fq < 2) {
        const f32x4 c0 = *(const f32x4*)cosr, c1 = *(const f32x4*)(cosr + 4), s0 = *(const f32x4*)sinr, s1 = *(const f32x4*)(sinr + 4);
        if (fq == 0) { v0 = v0 * c0 - p0 * s0; v1 = v1 * c1 - p1 * s1; }
        else { v0 = v0 * c0 + p0 * s0; v1 = v1 * c1 + p1 * s1; }
    }
}
__device__ __forceinline__ u32x4 pack8(f32x4 v0, f32x4 v1) { u32x4 w; w.x = cvt_pk_bf16(v0[0], v0[1]); w.y = cvt_pk_bf16(v0[2], v0[3]); w.z = cvt_pk_bf16(v1[0], v1[1]); w.w = cvt_pk_bf16(v1[2], v1[3]); return w; }

struct EpiUG {
    static constexpr bool PERM = true;
    bf16* U; bf16* G; float* pool_out;
    __device__ __forceinline__ void operator()(const f32x4 (&acc)[2][2][4][2], const pg8::Unit& u, int wr, int wc, int fr, int fq) const {
        const int row0 = u.pm * 256 + wr * 64 + fr; const bool isu = u.pn < 8; const int col0 = (isu ? u.pn : u.pn - 8) * 256 + wc * 32 + 8 * fq;
#pragma unroll
        for (int ai = 0; ai < 2; ++ai)
#pragma unroll
            for (int m = 0; m < 4; ++m) { const int row = row0 + ai * 128 + m * 16; const int t = row & (SEQ - 1), b = row >> 11;
#pragma unroll
                for (int bj = 0; bj < 2; ++bj) { f32x4 v0 = acc[ai][bj][m][0], v1 = acc[ai][bj][m][1]; const int col = col0 + bj * 128;
                    if (isu) { *(u32x4*)(U + (size_t)row * DM + col) = pack8(v0, v1);
                        if (t >= SEQ - PST) { float* op = pool_out + ((size_t)(b * PST + (t - (SEQ - PST))) * DM + col); *(f32x4*)op = v0; *(f32x4*)(op + 4) = v1; } }
                    else { *(u32x4*)(G + (size_t)row * DM + col) = pack8(silu4(v0), silu4(v1)); } } }
    }
};
struct EpiQG {
    static constexpr bool PERM = true;
    bf16* Q; bf16* G; const float* cosT; const float* sinT;
    __device__ __forceinline__ void operator()(const f32x4 (&acc)[2][2][4][2], const pg8::Unit& u, int wr, int wc, int fr, int fq) const {
        const int row0 = u.pm * 256 + wr * 64 + fr; const bool isq = u.pn < 8; const int col0 = (isq ? u.pn : u.pn - 8) * 256 + wc * 32 + 8 * fq;
#pragma unroll
        for (int ai = 0; ai < 2; ++ai)
#pragma unroll
            for (int m = 0; m < 4; ++m) { const int row = row0 + ai * 128 + m * 16; const int t = row & (SEQ - 1);
#pragma unroll
                for (int bj = 0; bj < 2; ++bj) { f32x4 v0 = acc[ai][bj][m][0], v1 = acc[ai][bj][m][1]; const int col = col0 + bj * 128;
                    if (isq) { if ((wc & 1) == 0) rope_perm(v0, v1, cosT + t * 8, sinT + t * 8, fq);
                        *(u32x4*)(Q + (size_t)row * DM + col) = pack8(v0 * QSCALE, v1 * QSCALE); }
                    else { *(u32x4*)(G + (size_t)row * DM + col) = pack8(silu4(v0), silu4(v1)); } } }
    }
};
struct EpiKV {
    static constexpr bool PERM = true;
    bf16* KB; bf16* VB; float* kout; float* vout; const float* cosT; const float* sinT;
    __device__ __forceinline__ void operator()(const f32x4 (&acc)[2][2][4][2], const pg8::Unit& u, int wr, int wc, int fr, int fq) const {
        const int row0 = u.pm * 256 + wr * 64 + fr; const bool isk = u.pn == 0; const int col0 = wc * 32 + 8 * fq;
        bf16* dst = isk ? KB : VB; float* fo = isk ? kout : vout;
#pragma unroll
        for (int ai = 0; ai < 2; ++ai)
#pragma unroll
            for (int m = 0; m < 4; ++m) { const int row = row0 + ai * 128 + m * 16; const int t = row & (SEQ - 1), b = row >> 11;
#pragma unroll
                for (int bj = 0; bj < 2; ++bj) { f32x4 v0 = acc[ai][bj][m][0], v1 = acc[ai][bj][m][1]; const int col = col0 + bj * 128;
                    if (isk && (wc & 1) == 0) rope_perm(v0, v1, cosT + t * 8, sinT + t * 8, fq);
                    *(u32x4*)(dst + (size_t)row * KVD + col) = pack8(v0, v1);
                    if (t >= SEQ - WIN) { float* op = fo + ((size_t)(b * WIN + (t - (SEQ - WIN))) * KVD + col); *(f32x4*)op = v0; *(f32x4*)(op + 4) = v1; } } }
    }
};
struct EpiGrp {
    static constexpr bool PERM = true;
    bf16* GE; const float* scale;
    __device__ __forceinline__ void operator()(const f32x4 (&acc)[2][2][4][2], const pg8::Unit& u, int wr, int wc, int fr, int fq) const {
        const int row0 = u.pm * 256 + wr * 64 + fr; const int col0 = u.pn * 256 + wc * 32 + 8 * fq;
        f32x4 sc[2][2];
#pragma unroll
        for (int bj = 0; bj < 2; ++bj) { sc[bj][0] = *(const f32x4*)(scale + col0 + bj * 128); sc[bj][1] = *(const f32x4*)(scale + col0 + bj * 128 + 4); }
#pragma unroll
        for (int ai = 0; ai < 2; ++ai)
#pragma unroll
            for (int m = 0; m < 4; ++m) { const int row = row0 + ai * 128 + m * 16;
#pragma unroll
                for (int bj = 0; bj < 2; ++bj) { bf16* p = GE + (size_t)row * DM + col0 + bj * 128; const u32x4 gv = *(const u32x4*)p;
                    f32x4 g0 = {__builtin_bit_cast(float, gv.x << 16), __builtin_bit_cast(float, gv.x & 0xffff0000u), __builtin_bit_cast(float, gv.y << 16), __builtin_bit_cast(float, gv.y & 0xffff0000u)};
                    f32x4 g1 = {__builtin_bit_cast(float, gv.z << 16), __builtin_bit_cast(float, gv.z & 0xffff0000u), __builtin_bit_cast(float, gv.w << 16), __builtin_bit_cast(float, gv.w & 0xffff0000u)};
                    *(u32x4*)p = pack8(acc[ai][bj][m][0] * sc[bj][0] * g0, acc[ai][bj][m][1] * sc[bj][1] * g1); } }
    }
};
struct EpiRes {
    static constexpr bool PERM = false;
    const float* xres; float* R;
    __device__ __forceinline__ void operator()(const f32x4 (&acc)[2][2][4][2], const pg8::Unit& u, int wr, int wc, int fr, int fq) const {
        const int row0 = u.pm * 256 + wr * 64 + fr; const int col0 = u.pn * 256 + wc * 32 + 4 * fq;
#pragma unroll
        for (int ai = 0; ai < 2; ++ai)
#pragma unroll
            for (int m = 0; m < 4; ++m) { const size_t off = (size_t)(row0 + ai * 128 + m * 16) * DM + col0;
#pragma unroll
                for (int bj = 0; bj < 2; ++bj)
#pragma unroll
                    for (int n = 0; n < 2; ++n) { const f32x4 xv = *(const f32x4*)(xres + off + bj * 128 + n * 16); *(f32x4*)(R + off + bj * 128 + n * 16) = xv * ALPHA + acc[ai][bj][m][n]; } }
    }
};

#define XB_TMO      128
#define XB_XCNT(j)  (256  + 64 * (j))
#define XB_XSUB(j)  (1280 + 64 * (j))
#define XB_XGEN(j)  (2304 + 64 * (j))
#define XB_TOP      3328
#define XB_TOPGEN   3392
#define XCD_BAR_WORDS 3456
#define XB_SPIN_CAP (1u << 18)
__device__ __forceinline__ unsigned xb_ld(unsigned* p)              { return __hip_atomic_load(p, __ATOMIC_RELAXED, __HIP_MEMORY_SCOPE_AGENT); }
__device__ __forceinline__ unsigned xb_add(unsigned* p, unsigned v) { return __hip_atomic_fetch_add(p, v, __ATOMIC_RELAXED, __HIP_MEMORY_SCOPE_AGENT); }
__device__ __forceinline__ unsigned xb_xcc_id() { return (unsigned)__builtin_amdgcn_s_getreg((3 << 11) | 20) & 0xFu; }
#define XB_SPIN(cond, bar) do { unsigned _sp = 0; while (cond) { __builtin_amdgcn_s_sleep(1); \
    if ((++_sp & 255u) == 0u) { if (xb_ld(&(bar)[XB_TMO])) break; if (_sp > XB_SPIN_CAP) { atomicAdd(&(bar)[XB_TMO], 1u); break; } } } } while (0)
struct XcdBarrier { unsigned* bar; unsigned x; volatile LAS unsigned* st; };
__device__ __forceinline__ XcdBarrier xcd_barrier_post(unsigned* bar, volatile LAS unsigned* st) {
    XcdBarrier b; b.bar = bar; b.x = xb_xcc_id(); b.st = st;
    if (threadIdx.x == 0) (void)xb_add(&bar[XB_XCNT(b.x)], 1u);
    return b;
}
__device__ __forceinline__ void xcd_barrier_complete(unsigned* bar, unsigned x, unsigned& nloc, unsigned& nx) {
    const unsigned G = gridDim.x * gridDim.y * gridDim.z;
    unsigned sum, cnt, mine, sp = 0u;
    for (;;) {
        sum = 0u; cnt = 0u; mine = 0u;
#pragma unroll
        for (unsigned j = 0; j < 16; ++j) { const unsigned c = xb_ld(&bar[XB_XCNT(j)]); sum += c; cnt += (c > 0u) ? 1u : 0u; mine = (j == x) ? c : mine; }
        if (sum == G) break;
        __builtin_amdgcn_s_sleep(1);
        if ((++sp & 255u) == 0u) { if (xb_ld(&bar[XB_TMO])) break; if (sp > XB_SPIN_CAP) { atomicAdd(&bar[XB_TMO], 1u); break; } }
    }
    nloc = mine > 0u ? mine : 1u; nx = cnt > 0u ? cnt : 1u;
}
__device__ __forceinline__ void xcd_barrier(const XcdBarrier& b) {
    asm volatile("s_waitcnt vmcnt(0)" ::: "memory");
    __syncthreads();
    if (threadIdx.x == 0) {
        unsigned* bar = b.bar;
        __builtin_amdgcn_s_waitcnt(0);
        unsigned nloc = b.st[0], nx = b.st[1];
        if (nloc == 0u) { xcd_barrier_complete(bar, b.x, nloc, nx); b.st[0] = nloc; b.st[1] = nx; }
        const unsigned old = xb_add(&bar[XB_XSUB(b.x)], 1u);
        const unsigned gen = old / nloc;
        if (old + 1u == (gen + 1u) * nloc) {
            __builtin_amdgcn_fence(__ATOMIC_RELEASE, "agent");
            asm volatile("s_waitcnt vmcnt(0)" ::: "memory");
            const unsigned og = xb_add(&bar[XB_TOP], 1u);
            const unsigned tg = og / nx;
            if (og + 1u == (tg + 1u) * nx) xb_add(&bar[XB_TOPGEN], 1u);
            else XB_SPIN(xb_ld(&bar[XB_TOPGEN]) == tg, bar);
            __builtin_amdgcn_fence(__ATOMIC_ACQUIRE, "agent");
            xb_add(&bar[XB_XGEN(b.x)], 1u);
            asm volatile("s_waitcnt vmcnt(0)" ::: "memory");
        } else {
            XB_SPIN(xb_ld(&bar[XB_XGEN(b.x)]) == gen, bar);
            __builtin_amdgcn_fence(__ATOMIC_ACQUIRE, "agent");
            asm volatile("s_waitcnt vmcnt(0)" ::: "memory");
        }
    }
    __syncthreads();
}

__device__ __forceinline__ float wave_sum(float v) {
#pragma unroll
    for (int o = 1; o < 64; o <<= 1) v += __shfl_xor(v, o);
    return v;
}
__device__ __forceinline__ float wave_max(float v) {
#pragma unroll
    for (int o = 1; o < 64; o <<= 1) v = fmaxf(v, __shfl_xor(v, o));
    return v;
}
__device__ __forceinline__ void p0_transpose_item(const float* W, int K, int N, bf16* WT, int row_off, LAS float* scr, int item, int lane) {
    const int nblk = N / 32, kb = item / nblk, nb = item % nblk, k0 = 64 * kb, n0 = 32 * nb;
#pragma unroll 8
    for (int i = 0; i < 32; ++i) { const int kk = 2 * i + (lane >> 5); scr[kk * 33 + (lane & 31)] = W[(size_t)(k0 + kk) * N + n0 + (lane & 31)]; }
    asm volatile("s_waitcnt lgkmcnt(0)" ::: "memory");
    const int c = lane & 7;
#pragma unroll
    for (int j = 0; j < 4; ++j) { const int n = (lane >> 3) + 8 * j; const LAS float* s = scr + (8 * c) * 33 + n;
        u32x4 o; o.x = pk2(s[0 * 33], s[1 * 33]); o.y = pk2(s[2 * 33], s[3 * 33]); o.z = pk2(s[4 * 33], s[5 * 33]); o.w = pk2(s[6 * 33], s[7 * 33]);
        *(u32x4*)(WT + (size_t)(row_off + n0 + n) * K + k0 + 8 * c) = o; }
    asm volatile("s_waitcnt lgkmcnt(0)" ::: "memory");
}
__device__ __forceinline__ float inv_freq_f(int j) {
    return __builtin_amdgcn_exp2f(-(float)j * (18.931568569324174f / 8.0f));
}

template <class F>
__device__ __forceinline__ void small_gemm(LAS unsigned char* lds, const bf16* As, int lda, const bf16* Bt, int ldb, int N, int K, int grp, int vcu, int G, const F& f) {
    const int tid = fresh_tid(), lane = tid & 63, wid = tid >> 6, l15 = lane & 15, lq = lane >> 4;
    const int kc = K / 8;
    LAS float* red = (LAS float*)lds;
    for (int cg = vcu; cg < N / 16; cg += G) {
        const int col0 = cg * 16; const int acol = grp ? (col0 >> 9) * 512 : 0;
        const bf16* ap = As + acol + wid * kc + lq * 8;
        const bf16* bp = Bt + (size_t)(col0 + l15) * ldb + wid * kc + lq * 8;
        f32x4 acc0 = {0.f, 0.f, 0.f, 0.f}, acc1 = {0.f, 0.f, 0.f, 0.f};
        for (int k = 0; k < kc; k += 32) {
            const bf16x8 bv = *(const bf16x8*)(bp + k);
            const bf16x8 a0 = *(const bf16x8*)(ap + (size_t)l15 * lda + k);
            const bf16x8 a1 = *(const bf16x8*)(ap + (size_t)(l15 + 16) * lda + k);
            acc0 = __builtin_amdgcn_mfma_f32_16x16x32_bf16(a0, bv, acc0, 0, 0, 0);
            acc1 = __builtin_amdgcn_mfma_f32_16x16x32_bf16(a1, bv, acc1, 0, 0, 0);
        }
#pragma unroll
        for (int j = 0; j < 4; ++j) { red[(wid * 32 + lq * 4 + j) * 16 + l15] = acc0[j]; red[(wid * 32 + 16 + lq * 4 + j) * 16 + l15] = acc1[j]; }
        __syncthreads();
        float s = 0.f;
#pragma unroll
        for (int w = 0; w < 8; ++w) s += red[w * 512 + tid];
        f(tid >> 4, col0 + (tid & 15), s);
        __syncthreads();
    }
}

template <int W>
__device__ __forceinline__ void pool_run(const bf16* U, bf16* D, int b, int t0, int c8) {
    constexpr int R = 32;
    const bf16* up = U + (size_t)b * SEQ * DM + c8 * 8; bf16* dp = D + (size_t)b * SEQ * DM + c8 * 8;
    float s[8];
#pragma unroll
    for (int i = 0; i < 8; ++i) s[i] = 0.f;
#pragma unroll
    for (int j = 1; j < W; ++j) { const int t = t0 - j; if (t >= 0) { const u32x4 v = *(const u32x4*)(up + (size_t)t * DM);
            s[0] += __builtin_bit_cast(float, v.x << 16); s[1] += __builtin_bit_cast(float, v.x & 0xffff0000u); s[2] += __builtin_bit_cast(float, v.y << 16); s[3] += __builtin_bit_cast(float, v.y & 0xffff0000u);
            s[4] += __builtin_bit_cast(float, v.z << 16); s[5] += __builtin_bit_cast(float, v.z & 0xffff0000u); s[6] += __builtin_bit_cast(float, v.w << 16); s[7] += __builtin_bit_cast(float, v.w & 0xffff0000u); } }
#pragma unroll 4
    for (int r = 0; r < R; ++r) { const int t = t0 + r; const u32x4 v = *(const u32x4*)(up + (size_t)t * DM);
        float x[8] = {__builtin_bit_cast(float, v.x << 16), __builtin_bit_cast(float, v.x & 0xffff0000u), __builtin_bit_cast(float, v.y << 16), __builtin_bit_cast(float, v.y & 0xffff0000u),
                      __builtin_bit_cast(float, v.z << 16), __builtin_bit_cast(float, v.z & 0xffff0000u), __builtin_bit_cast(float, v.w << 16), __builtin_bit_cast(float, v.w & 0xffff0000u)};
        const float ic = 1.0f / (float)(t + 1 < W ? t + 1 : W);
        float o[8];
#pragma unroll
        for (int i = 0; i < 8; ++i) { s[i] += x[i]; o[i] = s[i] * ic - x[i]; }
        u32x4 w; w.x = pk2(o[0], o[1]); w.y = pk2(o[2], o[3]); w.z = pk2(o[4], o[5]); w.w = pk2(o[6], o[7]);
        *(u32x4*)(dp + (size_t)t * DM) = w;
        const int tl = t - W + 1;
        if (tl >= 0) { const u32x4 q = *(const u32x4*)(up + (size_t)tl * DM);
            s[0] -= __builtin_bit_cast(float, q.x << 16); s[1] -= __builtin_bit_cast(float, q.x & 0xffff0000u); s[2] -= __builtin_bit_cast(float, q.y << 16); s[3] -= __builtin_bit_cast(float, q.y & 0xffff0000u);
            s[4] -= __builtin_bit_cast(float, q.z << 16); s[5] -= __builtin_bit_cast(float, q.z & 0xffff0000u); s[6] -= __builtin_bit_cast(float, q.w << 16); s[7] -= __builtin_bit_cast(float, q.w & 0xffff0000u); } }
}

__device__ __forceinline__ void ln_row(float* row, bf16* orow, const float* g, const float* bta, int lane) {
    f32x4* xr = (f32x4*)row + lane;
    f32x4 v[8]; float s = 0.f;
#pragma unroll
    for (int j = 0; j < 8; ++j) { v[j] = xr[64 * j]; s += (v[j][0] + v[j][1]) + (v[j][2] + v[j][3]); }
    const float mean = wave_sum(s) * (1.f / DM); float s2 = 0.f;
#pragma unroll
    for (int j = 0; j < 8; ++j) { v[j] = v[j] - mean; s2 += (v[j][0] * v[j][0] + v[j][1] * v[j][1]) + (v[j][2] * v[j][2] + v[j][3] * v[j][3]); }
    const float rstd = 1.f / sqrtf(wave_sum(s2) * (1.f / DM) + LN_EPS);
#pragma unroll
    for (int j = 0; j < 8; ++j) { const f32x4 gv = *((const f32x4*)g + lane + 64 * j), bv = *((const f32x4*)bta + lane + 64 * j);
        const f32x4 o = v[j] * rstd * gv + bv; xr[64 * j] = o;
        if (orow) { u32x2 w; w.x = pk2(o[0], o[1]); w.y = pk2(o[2], o[3]); *((u32x2*)orow + lane + 64 * j) = w; } }
}

__device__ __forceinline__ int crow(int r, int hi) { return (r & 3) + 8 * (r >> 2) + 4 * hi; }
constexpr int KS_STRIDE = 144, VT_STRIDE = 520, VT_OFF = 256 * KS_STRIDE;
__device__ __forceinline__ void attn_unit(LAS unsigned char* lds, int b, int nb, int kvh, const bf16* Q, const bf16* KB, const bf16* VB, bf16* GE, const float* sinks) {
    const int tid = fresh_tid(), lane = tid & 63, wid = tid >> 6, r32 = lane & 31, hi = lane >> 5;
    LAS unsigned char* Ks = lds; LAS unsigned char* Vt = lds + VT_OFF;
    const int kbase = WIN * (nb - 1);
    for (int c = tid; c < 2048; c += 512) { const int kk = c >> 3, c8 = c & 7, kp = kbase + kk;
        if (kp >= 0) { const u32x4 v = *(const u32x4*)(KB + (size_t)(b * SEQ + kp) * KVD + kvh * HD + c8 * 8); *(LAS u32x4*)(Ks + kk * KS_STRIDE + c8 * 16) = v; } }
    for (int c = tid; c < 2048; c += 512) { const int c8 = c >> 8, kk = c & 255, kp = kbase + kk;
        if (kp >= 0) { const u32x4 v = *(const u32x4*)(VB + (size_t)(b * SEQ + kp) * KVD + kvh * HD + c8 * 8);
            LAS unsigned short* vp = (LAS unsigned short*)(Vt + (c8 * 8) * VT_STRIDE + kk * 2);
            vp[0 * (VT_STRIDE / 2)] = (unsigned short)(v.x & 0xffffu); vp[1 * (VT_STRIDE / 2)] = (unsigned short)(v.x >> 16);
            vp[2 * (VT_STRIDE / 2)] = (unsigned short)(v.y & 0xffffu); vp[3 * (VT_STRIDE / 2)] = (unsigned short)(v.y >> 16);
            vp[4 * (VT_STRIDE / 2)] = (unsigned short)(v.z & 0xffffu); vp[5 * (VT_STRIDE / 2)] = (unsigned short)(v.z >> 16);
            vp[6 * (VT_STRIDE / 2)] = (unsigned short)(v.w & 0xffffu); vp[7 * (VT_STRIDE / 2)] = (unsigned short)(v.w >> 16); } }
    __syncthreads();
    const int h = kvh * 8 + wid;
    const float sink = sinks[h] * LOG2E;
    const float NEGINF = -__builtin_inff();
    for (int s = 0; s < 4; ++s) {
        const size_t qrow = (size_t)(b * SEQ + nb * WIN + s * 32 + r32);
        bf16x8 qf[4];
#pragma unroll
        for (int ks = 0; ks < 4; ++ks) qf[ks] = *(const bf16x8*)(Q + qrow * DM + h * HD + ks * 16 + hi * 8);
        f32x16 st[5];
#pragma unroll
        for (int tt = 0; tt < 5; ++tt) {
            const int kt = s + tt; const bool valid = (nb > 0) || (kt >= 4);
#pragma unroll
            for (int r = 0; r < 16; ++r) st[tt][r] = valid ? 0.f : NEGINF;
            if (valid) {
#pragma unroll
                for (int ks = 0; ks < 4; ++ks) { const bf16x8 kf = *(const LAS bf16x8*)(Ks + (32 * kt + r32) * KS_STRIDE + ks * 32 + hi * 16);
                    st[tt] = __builtin_amdgcn_mfma_f32_32x32x16_bf16(kf, qf[ks], st[tt], 0, 0, 0); }
            }
        }
        float mx = sink;
#pragma unroll
        for (int r = 0; r < 16; ++r) { const int kl = crow(r, hi); if (kl <= r32) st[0][r] = NEGINF; if (kl > r32) st[4][r] = NEGINF; }
#pragma unroll
        for (int tt = 0; tt < 5; ++tt)
#pragma unroll
            for (int r = 0; r < 16; ++r) mx = fmaxf(mx, st[tt][r]);
        mx = fmaxf(mx, __shfl_xor(mx, 32));
        float lsum = 0.f;
#pragma unroll
        for (int tt = 0; tt < 5; ++tt)
#pragma unroll
            for (int r = 0; r < 16; ++r) { const float p = __builtin_amdgcn_exp2f(st[tt][r] - mx); lsum += p; st[tt][r] = p; }
        lsum += __shfl_xor(lsum, 32); lsum += __builtin_amdgcn_exp2f(sink - mx);
        f32x16 ot[2];
#pragma unroll
        for (int r = 0; r < 16; ++r) { ot[0][r] = 0.f; ot[1][r] = 0.f; }
#pragma unroll
        for (int tt = 0; tt < 5; ++tt) {
            const int kt = s + tt; const bool valid = (nb > 0) || (kt >= 4);
            if (valid) {
#pragma unroll
                for (int k2 = 0; k2 < 2; ++k2) {
                    u32x4 pw; pw.x = cvt_pk_bf16(st[tt][8 * k2 + 0], st[tt][8 * k2 + 1]); pw.y = cvt_pk_bf16(st[tt][8 * k2 + 2], st[tt][8 * k2 + 3]);
                    pw.z = cvt_pk_bf16(st[tt][8 * k2 + 4], st[tt][8 * k2 + 5]); pw.w = cvt_pk_bf16(st[tt][8 * k2 + 6], st[tt][8 * k2 + 7]);
                    const bf16x8 pb = __builtin_bit_cast(bf16x8, pw);
#pragma unroll
                    for (int db = 0; db < 2; ++db) { const LAS unsigned char* vp = Vt + (32 * db + r32) * VT_STRIDE + (32 * kt + 16 * k2 + 4 * hi) * 2;
                        const u32x2 lo = *(const LAS u32x2*)vp, hi4 = *(const LAS u32x2*)(vp + 16);
                        u32x4 vw; vw.x = lo.x; vw.y = lo.y; vw.z = hi4.x; vw.w = hi4.y;
                        ot[db] = __builtin_amdgcn_mfma_f32_32x32x16_bf16(__builtin_bit_cast(bf16x8, vw), pb, ot[db], 0, 0, 0); }
                }
            }
        }
        const float inv = 1.0f / lsum;
#pragma unroll
        for (int db = 0; db < 2; ++db)
#pragma unroll
            for (int rg = 0; rg < 4; ++rg) { bf16* p = GE + qrow * DM + h * HD + 32 * db + 8 * rg + 4 * hi; const u32x2 gv = *(const u32x2*)p;
                const float g0 = __builtin_bit_cast(float, gv.x << 16), g1 = __builtin_bit_cast(float, gv.x & 0xffff0000u), g2 = __builtin_bit_cast(float, gv.y << 16), g3 = __builtin_bit_cast(float, gv.y & 0xffff0000u);
                u32x2 w; w.x = cvt_pk_bf16(ot[db][4 * rg + 0] * inv * g0, ot[db][4 * rg + 1] * inv * g1); w.y = cvt_pk_bf16(ot[db][4 * rg + 2] * inv * g2, ot[db][4 * rg + 3] * inv * g3);
                *(u32x2*)p = w; }
    }
    __syncthreads();
}

__device__ __forceinline__ void sample_attn(LAS float* pl, int b, int h, const float* qs, const float* kx, const float* vx, const float* gs, bf16* esb, const float* sinks, int lane) {
    const int kvh = h >> 3;
    const float* q = qs + (size_t)b * DM + h * HD;
    float s0 = 0.f, s1 = 0.f;
    const float* k0 = kx + ((size_t)(b * WIN + lane) * KVD + kvh * HD); const float* k1 = k0 + (size_t)64 * KVD;
#pragma unroll 4
    for (int d = 0; d < HD; d += 4) { const f32x4 qv = *(const f32x4*)(q + d); const f32x4 a = *(const f32x4*)(k0 + d), c = *(const f32x4*)(k1 + d);
        s0 += qv[0] * a[0] + qv[1] * a[1] + qv[2] * a[2] + qv[3] * a[3]; s1 += qv[0] * c[0] + qv[1] * c[1] + qv[2] * c[2] + qv[3] * c[3]; }
    const float sink = sinks[h] * LOG2E;
    const float mx = fmaxf(wave_max(fmaxf(s0, s1)), sink);
    const float p0 = __builtin_amdgcn_exp2f(s0 - mx), p1 = __builtin_amdgcn_exp2f(s1 - mx);
    const float l = wave_sum(p0 + p1) + __builtin_amdgcn_exp2f(sink - mx);
    pl[lane] = p0; pl[lane + 64] = p1;
    asm volatile("s_waitcnt lgkmcnt(0)" ::: "memory");
    float o = 0.f; const float* vp = vx + ((size_t)b * WIN * KVD + kvh * HD + lane);
#pragma unroll 8
    for (int k = 0; k < WIN; ++k) o += pl[k] * vp[(size_t)k * KVD];
    const float e = o / l * gs[(size_t)b * DM + h * HD + lane];
    esb[(size_t)b * DM + h * HD + lane] = (bf16)f2bf(e);
    asm volatile("s_waitcnt lgkmcnt(0)" ::: "memory");
}

struct Args { const float* in[15]; float* out; unsigned char* ws; };

__global__ void __launch_bounds__(NWAVES * 64, 2) yoco_fwd(Args args) {
    extern __shared__ __attribute__((aligned(16))) unsigned char lds_raw[];
    LAS unsigned char* lds = (LAS unsigned char*)lds_raw;
    volatile LAS unsigned* MISC = (volatile LAS unsigned*)(lds + MISC_OFF);
    const int G = gridDim.x, bx = blockIdx.x;
#define PHASE_IDS() const int tid = fresh_tid(), lane = tid & 63, wave = __builtin_amdgcn_readfirstlane(tid >> 6); const int gw = vcu * NWAVES + wave, NGW = G * NWAVES; const int gt = vcu * (NWAVES * 64) + tid, NGT = G * NWAVES * 64; (void)lane; (void)gw; (void)NGW; (void)gt; (void)NGT
    const int vcu = (G % 8 == 0) ? (bx % 8) * (G / 8) + bx / 8 : bx;
    unsigned char* ws = args.ws; float* out = args.out;
    const float* x_prompt = args.in[0]; const float* x_sample = args.in[1]; const float* state_pool = args.in[2]; const float* cache_k = args.in[3]; const float* cache_v = args.in[4];
    const float* w_in_a = args.in[5]; const float* w_grp_a = args.in[6]; const float* scale_a = args.in[7]; const float* w_out_a = args.in[8]; const float* w_kv = args.in[9];
    const float* w_in_b = args.in[10]; const float* sinks_b = args.in[11]; const float* w_out_b = args.in[12]; const float* ln_g = args.in[13]; const float* ln_b = args.in[14];
    bf16* WinA = (bf16*)(ws + WS_WINA); bf16* Wgrp = (bf16*)(ws + WS_WGRP); bf16* WoutA = (bf16*)(ws + WS_WOUTA); bf16* Wkv = (bf16*)(ws + WS_WKV);
    bf16* WinB = (bf16*)(ws + WS_WINB); bf16* WoutB = (bf16*)(ws + WS_WOUTB);
    bf16* XB = (bf16*)(ws + WS_XB); bf16* Ub = (bf16*)(ws + WS_U); bf16* Gb = (bf16*)(ws + WS_G); bf16* Db = (bf16*)(ws + WS_D); bf16* KB = (bf16*)(ws + WS_KB); bf16* VB = (bf16*)(ws + WS_VB);
    bf16* XSB = (bf16*)(ws + SM_XSB); float* US = (float*)(ws + SM_US); float* GS = (float*)(ws + SM_GS); bf16* DSB = (bf16*)(ws + SM_DSB); bf16* ESB = (bf16*)(ws + SM_ESB); float* QS = (float*)(ws + SM_QS);
    float* cosT = (float*)(ws + WS_ROPE); float* sinT = cosT + 2049 * 8;
    float* XF = out + O_YP; float* XSF = out + O_YS;

    for (int u = threadIdx.x; u < (LDS_BYTES - RING_BYTES) / 4; u += NWAVES * 64) ((LAS unsigned*)(lds + RING_BYTES))[u] = 0u;
    __syncthreads();
    XcdBarrier bar = xcd_barrier_post((unsigned*)(ws + WS_CTL) + CW_BAR, MISC + 8);

    {
        PHASE_IDS();
        LAS float* scr = (LAS float*)(lds + wave * 16384);
        constexpr int I_IN = 32 * 128, I_GRP = 8 * 16, I_OUT = 32 * 64, I_KV = 32 * 16;
        constexpr int NITEMS = 4 * I_IN + 8 * I_GRP + 4 * I_OUT + I_KV;
        for (int it = gw; it < NITEMS; it += NGW) {
            int r = it;
            if (r < 2 * I_IN) { const int i = r / I_IN; p0_transpose_item(w_in_a + (size_t)i * DM * 4096, DM, 4096, WinA + (size_t)i * 4096 * DM, 0, scr, r % I_IN, lane); continue; } r -= 2 * I_IN;
            if (r < 2 * I_IN) { const int i = r / I_IN; p0_transpose_item(w_in_b + (size_t)i * DM * 4096, DM, 4096, WinB + (size_t)i * 4096 * DM, 0, scr, r % I_IN, lane); continue; } r -= 2 * I_IN;
            if (r < 2 * I_OUT) { const int i = r / I_OUT; p0_transpose_item(w_out_a + (size_t)i * DM * DM, DM, DM, WoutA + (size_t)i * DM * DM, 0, scr, r % I_OUT, lane); continue; } r -= 2 * I_OUT;
            if (r < 2 * I_OUT) { const int i = r / I_OUT; p0_transpose_item(w_out_b + (size_t)i * DM * DM, DM, DM, WoutB + (size_t)i * DM * DM, 0, scr, r % I_OUT, lane); continue; } r -= 2 * I_OUT;
            if (r < I_KV) { p0_transpose_item(w_kv, DM, 512, Wkv, 0, scr, r, lane); continue; } r -= I_KV;
            { const int ig = r / I_GRP, i = ig >> 2, gI = ig & 3; p0_transpose_item(w_grp_a + (size_t)ig * 512 * 512, 512, 512, Wgrp + (size_t)i * DM * 512, gI * 512, scr, r % I_GRP, lane); }
        }
        for (size_t c = gt; c < (size_t)M * DM / 8; c += NGT) { const f32x4 a = *((const f32x4*)x_prompt + 2 * c), d = *((const f32x4*)x_prompt + 2 * c + 1);
            u32x4 w; w.x = pk2(a[0], a[1]); w.y = pk2(a[2], a[3]); w.z = pk2(d[0], d[1]); w.w = pk2(d[2], d[3]); *((u32x4*)XB + c) = w; }
        for (int c = gt; c < NSMP * DM / 8; c += NGT) { const f32x4 a = *((const f32x4*)x_sample + 2 * c), d = *((const f32x4*)x_sample + 2 * c + 1);
            u32x4 w; w.x = pk2(a[0], a[1]); w.y = pk2(a[2], a[3]); w.z = pk2(d[0], d[1]); w.w = pk2(d[2], d[3]); *((u32x4*)XSB + c) = w; }
        for (int i = gt; i < 2049 * 8; i += NGT) { const int pi = i >> 3, j = i & 7; const int pos = pi < SEQ ? pi : PAST;
            const double ang = (double)((float)pos * inv_freq_f(j)); double rev = ang * 0.15915494309189535; rev -= __builtin_rint(rev);
            const float fr = (float)rev; cosT[i] = __builtin_amdgcn_cosf(fr); sinT[i] = __builtin_amdgcn_sinf(fr); }
        for (int c = gt; c < NSMP * 127 * (KVD / 4); c += NGT) { const int b = c / (127 * 64), rem = c % (127 * 64);
            *((f32x4*)(out + O_KS + (size_t)b * WIN * KVD) + rem) = *((const f32x4*)(cache_k + (size_t)b * WIN * KVD + KVD) + rem);
            *((f32x4*)(out + O_VS + (size_t)b * WIN * KVD) + rem) = *((const f32x4*)(cache_v + (size_t)b * WIN * KVD + KVD) + rem); }
    }
    xcd_barrier(bar);

    for (int li = 0; li < 2; ++li) {
        const float* xres = li == 0 ? x_prompt : XF; const float* xsres = li == 0 ? x_sample : XSF;
        { pg8::Gemm g{XB, WinA + (size_t)li * 4096 * DM, DM, DM, DM, 0}; pg8::StaticOrder S; S.init(M, 4096, G, bx);
          EpiUG E{Ub, Gb, out + O_PP + (size_t)li * NBATCH * PST * DM};
          pg8::gemm_phase<EpiUG, pg8::StaticOrder, true>(lds, g, S, E);
          small_gemm(lds, XSB, DM, WinA + (size_t)li * 4096 * DM, DM, 4096, DM, 0, vcu, G, [&](int row, int col, float v) {
              if (col < DM) US[row * DM + col] = v; else GS[row * DM + col - DM] = silu_f(v); }); }
        xcd_barrier(bar);
        { PHASE_IDS();
          for (int item = gw; item < NBATCH * (SEQ / 32) * 4; item += NGW) { const int grp = item & 3, rb = item >> 2, b = rb / (SEQ / 32), t0 = (rb % (SEQ / 32)) * 32; const int c8 = grp * 64 + lane;
              if (grp == 0) pool_run<2>(Ub, Db, b, t0, c8); else if (grp == 1) pool_run<4>(Ub, Db, b, t0, c8); else if (grp == 2) pool_run<8>(Ub, Db, b, t0, c8); else pool_run<16>(Ub, Db, b, t0, c8); }
          if (gt < NSMP * DM) { const int b = gt >> 11, c = gt & (DM - 1); const int grp = c >> 9, w = 2 << grp;
              const float* sp = state_pool + ((size_t)(li * NSMP + b) * PST) * DM + c; float* op = out + O_PS + ((size_t)(li * NSMP + b) * PST) * DM + c;
              const float us = US[b * DM + c]; float sum = us;
#pragma unroll
              for (int r = 0; r < PST; ++r) { const float v = sp[(size_t)r * DM]; if (r >= 1) op[(size_t)(r - 1) * DM] = v; if (PST - r < w) sum += v; }
              op[(size_t)(PST - 1) * DM] = us;
              DSB[b * DM + c] = (bf16)f2bf(sum / (float)w - us); } }
        xcd_barrier(bar);
        { pg8::Gemm g{Db, Wgrp + (size_t)li * DM * 512, DM, 512, 512, 1}; pg8::StaticOrder S; S.init(M, DM, G, bx);
          EpiGrp E{Gb, scale_a + li * DM};
          pg8::gemm_phase<EpiGrp, pg8::StaticOrder, false>(lds, g, S, E);
          const float* sc = scale_a + li * DM;
          small_gemm(lds, DSB, DM, Wgrp + (size_t)li * DM * 512, 512, DM, 512, 1, vcu, G, [&](int row, int col, float v) {
              ESB[row * DM + col] = (bf16)f2bf(v * sc[col] * GS[row * DM + col]); }); }
        xcd_barrier(bar);
        { pg8::Gemm g{Gb, WoutA + (size_t)li * DM * DM, DM, DM, DM, 0}; pg8::StaticOrder S; S.init(M, DM, G, bx);
          EpiRes E{xres, XF};
          pg8::gemm_phase<EpiRes, pg8::StaticOrder, false>(lds, g, S, E);
          small_gemm(lds, ESB, DM, WoutA + (size_t)li * DM * DM, DM, DM, DM, 0, vcu, G, [&](int row, int col, float v) {
              XSF[row * DM + col] = ALPHA * xsres[row * DM + col] + v; }); }
        xcd_barrier(bar);
        { PHASE_IDS();
          for (int r = gw; r < M + NSMP; r += NGW) { if (r < M) ln_row(XF + (size_t)r * DM, XB + (size_t)r * DM, ln_g + li * DM, ln_b + li * DM, lane);
              else ln_row(XSF + (size_t)(r - M) * DM, XSB + (size_t)(r - M) * DM, ln_g + li * DM, ln_b + li * DM, lane); } }
        xcd_barrier(bar);
    }
    { pg8::Gemm g{XB, Wkv, DM, DM, DM, 0}; pg8::StaticOrder S; S.init(M, 512, G, bx);
      EpiKV E{KB, VB, out + O_KP, out + O_VP, cosT, sinT};
      pg8::gemm_phase<EpiKV, pg8::StaticOrder, false>(lds, g, S, E);
      small_gemm(lds, XSB, DM, Wkv, DM, 512, DM, 0, vcu, G, [&](int row, int col, float v) {
          if (col < KVD) { const float p = __shfl_xor(v, 8); const int d = col & 63;
              if (d < 16) { const float c = cosT[SEQ * 8 + (d & 7)], s = sinT[SEQ * 8 + (d & 7)]; v = d < 8 ? v * c - p * s : v * c + p * s; }
              out[O_KS + ((size_t)row * WIN + 127) * KVD + col] = v; }
          else out[O_VS + ((size_t)row * WIN + 127) * KVD + col - KVD] = v; }); }
    xcd_barrier(bar);
    for (int lj = 0; lj < 2; ++lj) {
        const int li = 2 + lj;
        { pg8::Gemm g{XB, WinB + (size_t)lj * 4096 * DM, DM, DM, DM, 0}; pg8::StaticOrder S; S.init(M, 4096, G, bx);
          EpiQG E{Ub, Gb, cosT, sinT};
          pg8::gemm_phase<EpiQG, pg8::StaticOrder, true>(lds, g, S, E);
          small_gemm(lds, XSB, DM, WinB + (size_t)lj * 4096 * DM, DM, 4096, DM, 0, vcu, G, [&](int row, int col, float v) {
              if (col < DM) { const float p = __shfl_xor(v, 8); const int d = col & 63;
                  if (d < 16) { const float c = cosT[SEQ * 8 + (d & 7)], s = sinT[SEQ * 8 + (d & 7)]; v = d < 8 ? v * c - p * s : v * c + p * s; }
                  QS[row * DM + col] = v * QSCALE; }
              else GS[row * DM + col - DM] = silu_f(v); }); }
        xcd_barrier(bar);
        { for (int u = vcu; u < NBATCH * 16 * NKV; u += G) { const int kvh = u & 3, nb = (u >> 2) & 15, b = u >> 6;
              attn_unit(lds, b, nb, kvh, Ub, KB, VB, Gb, sinks_b + lj * NH); }
          PHASE_IDS();
          LAS float* pl = (LAS float*)(lds + 73728 + wave * 512);
          for (int p = gw; p < NSMP * NH; p += NGW) sample_attn(pl, p >> 5, p & 31, QS, out + O_KS, out + O_VS, GS, ESB, sinks_b + lj * NH, lane); }
        xcd_barrier(bar);
        { pg8::Gemm g{Gb, WoutB + (size_t)lj * DM * DM, DM, DM, DM, 0}; pg8::StaticOrder S; S.init(M, DM, G, bx);
          EpiRes E{XF, XF};
          pg8::gemm_phase<EpiRes, pg8::StaticOrder, false>(lds, g, S, E);
          small_gemm(lds, ESB, DM, WoutB + (size_t)lj * DM * DM, DM, DM, DM, 0, vcu, G, [&](int row, int col, float v) {
              XSF[row * DM + col] = ALPHA * XSF[row * DM + col] + v; }); }
        xcd_barrier(bar);
        { PHASE_IDS(); const bool lastl = lj == 1;
          for (int r = gw; r < M + NSMP; r += NGW) { if (r < M) ln_row(XF + (size_t)r * DM, lastl ? nullptr : XB + (size_t)r * DM, ln_g + li * DM, ln_b + li * DM, lane);
              else ln_row(XSF + (size_t)(r - M) * DM, lastl ? nullptr : XSB + (size_t)(r - M) * DM, ln_g + li * DM, ln_b + li * DM, lane); } }
        if (lj == 0) xcd_barrier(bar);
    }
}

extern "C" void kernel_launch(void* const* d_in, const int* in_sizes, int n_in, void* d_out, int out_size, void* d_ws, size_t ws_size, hipStream_t stream) {
    static int grid = 0;
    if (grid == 0) {
        if (n_in != 15 || (size_t)out_size != O_END || ws_size < WS_END) { fprintf(stderr, "kernel_launch: unexpected shapes: n_in %d out %d ws %zu\n", n_in, out_size, ws_size); grid = -1; return; }
        int dev = 0, cus = 0, per_cu = 0;
        if (hipGetDevice(&dev) != hipSuccess || hipDeviceGetAttribute(&cus, hipDeviceAttributeMultiprocessorCount, dev) != hipSuccess) { grid = -1; return; }
        if (hipFuncSetAttribute((const void*)yoco_fwd, hipFuncAttributeMaxDynamicSharedMemorySize, LDS_BYTES) != hipSuccess) { fprintf(stderr, "kernel_launch: hipFuncSetAttribute failed\n"); grid = -1; return; }
        if (hipOccupancyMaxActiveBlocksPerMultiprocessor(&per_cu, (const void*)yoco_fwd, NWAVES * 64, LDS_BYTES) != hipSuccess || per_cu < 1) { fprintf(stderr, "kernel_launch: occupancy query says %d\n", per_cu); per_cu = 1; }
        (void)hipGetLastError();
        grid = cus;
        if (grid > cus * per_cu) grid = cus * per_cu;
    }
    if (grid < 0) return;
    (void)hipMemsetAsync((char*)d_ws + WS_CTL, 0, CTL_ZERO_BYTES, stream);
    Args a{};
    for (int i = 0; i < 15; ++i) a.in[i] = (const float*)d_in[i];
    a.out = (float*)d_out; a.ws = (unsigned char*)d_ws;
    void* kargs[] = {&a};
    hipError_t e = hipLaunchCooperativeKernel((const void*)yoco_fwd, dim3(grid), dim3(NWAVES * 64), kargs, LDS_BYTES, stream);
    if (e != hipSuccess) fprintf(stderr, "kernel_launch: cooperative launch failed: %s (grid %d)\n", hipGetErrorString(e), grid);
}
```
